# Optimizing an MI355X kernel written in HIP

```python
import math
import jax
import jax.numpy as jnp
from jax import lax
import numpy as np

D_MODEL = 1024
BATCH = 8
SEQ = 4096
DEPTH = 2

CHUNK = 64
Q_BLOCK = 128

N_MIXERS = 4
HEAD_DIM = 64
GROUP_WIDTH = D_MODEL // N_MIXERS
N_HEADS_GROUP = GROUP_WIDTH // HEAD_DIM
D_MIX = N_MIXERS * GROUP_WIDTH

MLA_Q_RANK = D_MODEL // 4
MLA_KV_RANK = D_MODEL // 8
MLA_NOPE_DIM = HEAD_DIM
MLA_ROPE_DIM = HEAD_DIM // 2
MLA_V_DIM = HEAD_DIM

RET_DECAY_OFFSET = 5.0

D_FF = 4 * D_MODEL

ROPE_BASE = 10000.0
EPS = 1e-6
FORGET_BIAS = 4.0

D_IN_PROJ = 10 * GROUP_WIDTH + N_HEADS_GROUP + MLA_Q_RANK + MLA_KV_RANK + MLA_ROPE_DIM

kernel_name = 'hybrid_fox_mla_retention_stickbreaking_trunk'

F32 = jnp.float32


def rms_norm(x, gain):
    xf = x.astype(F32)
    y = xf * lax.rsqrt(jnp.mean(xf * xf, axis=-1, keepdims=True) + EPS)
    return (y * gain.astype(F32)).astype(x.dtype)


def head_group_norm(o, gain):
    mu = jnp.mean(o, axis=-1, keepdims=True)
    var = jnp.mean(jnp.square(o - mu), axis=-1, keepdims=True)
    y = (o - mu) * lax.rsqrt(var + EPS)
    return y * gain.astype(F32).reshape(o.shape[2], o.shape[3])


def apply_rope(x, positions):
    half = x.shape[-1] // 2
    inv_freq = ROPE_BASE ** (-jnp.arange(half, dtype=F32) / half)
    ang = positions.astype(F32)[:, :, None, None] * inv_freq
    cos, sin = jnp.cos(ang), jnp.sin(ang)
    xf = x.astype(F32)
    x1, x2 = xf[..., :half], xf[..., half:]
    return jnp.concatenate([x1 * cos - x2 * sin, x1 * sin + x2 * cos], axis=-1).astype(x.dtype)


def to_blocks(t):
    b, s = t.shape[:2]
    return jnp.moveaxis(t.reshape((b, s // Q_BLOCK, Q_BLOCK) + t.shape[2:]), 1, 0)


def from_blocks(t):
    nb, b, qb = t.shape[:3]
    return jnp.moveaxis(t, 0, 1).reshape((b, nb * qb) + t.shape[3:])


def forgetting_attention(q, k, v, f_logit):
    seq = q.shape[1]
    scale = q.shape[-1] ** -0.5
    cum = jnp.cumsum(jax.nn.log_sigmoid(f_logit.astype(F32)), axis=1)
    cum_k = jnp.swapaxes(cum, 1, 2)
    k_pos = jnp.arange(seq)
    q_pos = k_pos.reshape(-1, Q_BLOCK)

    def block(xs):
        qb, cqb, qp = xs
        s = jnp.einsum('bqhd,bkhd->bhqk', qb, k, preferred_element_type=F32) * scale
        s = s + jnp.swapaxes(cqb, 1, 2)[..., None] - cum_k[:, :, None, :]
        s = jnp.where(k_pos[None, :] <= qp[:, None], s, -jnp.inf)
        p = jax.nn.softmax(s, axis=-1)
        return jnp.einsum('bhqk,bkhd->bqhd', p.astype(v.dtype), v)

    return from_blocks(lax.map(block, (to_blocks(q), to_blocks(cum), q_pos)))


def chunk_causal_softmax_attention(q, k, v):
    seq = q.shape[1]
    scale = q.shape[-1] ** -0.5
    k_chunk = jnp.arange(seq) // CHUNK
    q_pos = jnp.arange(seq).reshape(-1, Q_BLOCK)

    def block(xs):
        qb, qp = xs
        s = jnp.einsum('bqhd,bkhd->bhqk', qb, k, preferred_element_type=F32) * scale
        s = jnp.where(k_chunk[None, :] <= (qp // CHUNK)[:, None], s, -jnp.inf)
        p = jax.nn.softmax(s, axis=-1)
        return jnp.einsum('bhqk,bkhd->bqhd', p.astype(v.dtype), v)

    return from_blocks(lax.map(block, (to_blocks(q), q_pos)))


def stick_breaking_attention(q, k, v):
    seq = q.shape[1]
    scale = q.shape[-1] ** -0.5
    k_pos = jnp.arange(seq)
    q_pos = k_pos.reshape(-1, Q_BLOCK)

    def block(xs):
        qb, qp = xs
        z = jnp.einsum('bqhd,bkhd->bhqk', qb, k, preferred_element_type=F32) * scale
        visible = k_pos[None, :] < qp[:, None]
        log_stay = jnp.where(visible, jax.nn.log_sigmoid(-z), 0.0)
        later = lax.cumsum(log_stay, axis=3, reverse=True) - log_stay
        w = jnp.where(visible, jnp.exp(jax.nn.log_sigmoid(z) + later), 0.0)
        return jnp.einsum('bhqk,bkhd->bqhd', w.astype(v.dtype), v)

    return from_blocks(lax.map(block, (to_blocks(q), q_pos)))


def chunkwise_retention(q, k, v, positions):
    b, seq, h, d = q.shape
    n = seq // CHUNK
    qf = apply_rope(q, positions).astype(F32)
    kf = apply_rope(k, positions).astype(F32) * (d ** -0.5)
    vf = v.astype(F32)
    log_gamma = jnp.log1p(-jnp.power(2.0, -RET_DECAY_OFFSET - jnp.arange(h, dtype=F32)))
    idx = jnp.arange(CHUNK, dtype=F32)
    qc = qf.reshape(b, n, CHUNK, h, d)
    kc = kf.reshape(b, n, CHUNK, h, d)
    vc = vf.reshape(b, n, CHUNK, h, d)
    intra_decay = jnp.exp(log_gamma[:, None, None] * jnp.abs(idx[:, None] - idx[None, :]))
    scores = jnp.einsum('bncht,bnmht->bnhcm', qc, kc) * intra_decay
    intra = jnp.einsum('bnhcm,bnmhe->bnche', scores, vc)
    k_tail = kc * jnp.exp(log_gamma[None, :] * (CHUNK - 1 - idx)[:, None])[None, None, :, :, None]
    chunk_kv = jnp.einsum('bnmht,bnmhe->nbhte', k_tail, vc)
    chunk_decay = jnp.exp(log_gamma * CHUNK)[None, :, None, None]

    def step(state, kv):
        return state * chunk_decay + kv, state

    _, prev_state = lax.scan(step, jnp.zeros((b, h, d, d), F32), chunk_kv)
    q_head = qc * jnp.exp(log_gamma[None, :] * (idx + 1.0)[:, None])[None, None, :, :, None]
    inter = jnp.einsum('bncht,nbhte->bnche', q_head, prev_state)
    return (intra + inter).reshape(b, seq, h, d)


def split_columns(proj):
    sizes = [GROUP_WIDTH, GROUP_WIDTH, GROUP_WIDTH, N_HEADS_GROUP,
             MLA_Q_RANK, MLA_KV_RANK, MLA_ROPE_DIM,
             GROUP_WIDTH, GROUP_WIDTH, GROUP_WIDTH, GROUP_WIDTH,
             GROUP_WIDTH, GROUP_WIDTH, GROUP_WIDTH]
    offsets = [int(o) for o in np.cumsum(sizes)[:-1]]
    return jnp.split(proj, offsets, axis=-1)


def hybrid_mixer(h, positions, w_in, b_forget, g_q_lora, w_q_up, g_kv_lora, w_kv_up, g_mix_out, w_out):
    b, seq, _ = h.shape
    heads = lambda t: t.reshape(b, seq, N_HEADS_GROUP, -1)
    proj = jnp.einsum('bsd,dn->bsn', h, w_in)
    (fq, fk, fv, ff, cq, ckv, kr, rq, rk, rv, rg, sq, sk, sv) = split_columns(proj)

    out_a = forgetting_attention(heads(fq), heads(fk), heads(fv), ff + b_forget)
    out_a = rms_norm(out_a.reshape(b, seq, GROUP_WIDTH), g_mix_out[0:GROUP_WIDTH])

    q = jnp.einsum('bsr,rn->bsn', rms_norm(cq, g_q_lora), w_q_up).reshape(b, seq, N_HEADS_GROUP, MLA_NOPE_DIM + MLA_ROPE_DIM)
    q = jnp.concatenate([q[..., :MLA_NOPE_DIM], apply_rope(q[..., MLA_NOPE_DIM:], positions)], axis=-1)
    kv = jnp.einsum('bsr,rn->bsn', rms_norm(ckv, g_kv_lora), w_kv_up).reshape(b, seq, N_HEADS_GROUP, MLA_NOPE_DIM + MLA_V_DIM)
    k_rope = apply_rope(kr[:, :, None, :], positions)
    k = jnp.concatenate([kv[..., :MLA_NOPE_DIM], jnp.broadcast_to(k_rope, (b, seq, N_HEADS_GROUP, MLA_ROPE_DIM))], axis=-1)
    out_b = chunk_causal_softmax_attention(q, k, kv[..., MLA_NOPE_DIM:])
    out_b = rms_norm(out_b.reshape(b, seq, GROUP_WIDTH), g_mix_out[GROUP_WIDTH:2 * GROUP_WIDTH])

    ret = chunkwise_retention(heads(rq), heads(rk), heads(rv), positions)
    ret = head_group_norm(ret, g_mix_out[2 * GROUP_WIDTH:3 * GROUP_WIDTH]).reshape(b, seq, GROUP_WIDTH)
    out_c = (ret * jax.nn.silu(rg.astype(F32))).astype(h.dtype)

    out_d = stick_breaking_attention(heads(sq), heads(sk), heads(sv))
    out_d = rms_norm(out_d.reshape(b, seq, GROUP_WIDTH), g_mix_out[3 * GROUP_WIDTH:])

    mixed = jnp.concatenate([out_a, out_b, out_c, out_d], axis=-1)
    return jnp.einsum('bsn,nd->bsd', mixed, w_out)


def squared_relu_mlp(h, w_up, w_down):
    u = jnp.square(jax.nn.relu(jnp.einsum('bsd,df->bsf', h, w_up)))
    return jnp.einsum('bsf,fd->bsd', u, w_down)


def setup_inputs(seed: int = 0) -> dict:
    key = jax.random.key(seed)
    ks = jax.random.split(key, 20)
    nrm = lambda k, shape, fan_in: jax.random.normal(k, shape, F32) * (fan_in ** -0.5)
    gain = lambda k, shape: 1.0 + 0.05 * jax.random.normal(k, shape, F32)
    x = jax.random.normal(ks[0], (BATCH, SEQ, D_MODEL), F32)
    start = jax.random.randint(ks[1], (BATCH, 1), 0, 1024, dtype=jnp.int32)
    positions = start + jnp.arange(SEQ, dtype=jnp.int32)[None, :]
    return {
        'x': x,
        'positions': positions,
        'g_mix_pre': gain(ks[2], (DEPTH, D_MODEL)),
        'w_in': nrm(ks[3], (DEPTH, D_MODEL, D_IN_PROJ), D_MODEL),
        'b_forget': FORGET_BIAS + 0.5 * jax.random.normal(ks[4], (DEPTH, N_HEADS_GROUP), F32),
        'g_q_lora': gain(ks[5], (DEPTH, MLA_Q_RANK)),
        'w_q_up': nrm(ks[6], (DEPTH, MLA_Q_RANK, N_HEADS_GROUP * (MLA_NOPE_DIM + MLA_ROPE_DIM)), MLA_Q_RANK),
        'g_kv_lora': gain(ks[7], (DEPTH, MLA_KV_RANK)),
        'w_kv_up': nrm(ks[8], (DEPTH, MLA_KV_RANK, N_HEADS_GROUP * (MLA_NOPE_DIM + MLA_V_DIM)), MLA_KV_RANK),
        'g_mix_out': gain(ks[9], (DEPTH, D_MIX)),
        'w_out': nrm(ks[10], (DEPTH, D_MIX, D_MODEL), D_MIX),
        'g_mix_post': gain(ks[11], (DEPTH, D_MODEL)),
        'g_ffn_pre': gain(ks[12], (DEPTH, D_MODEL)),
        'w_ffn_up': nrm(ks[13], (DEPTH, D_MODEL, D_FF), D_MODEL),
        'w_ffn_down': nrm(ks[14], (DEPTH, D_FF, D_MODEL), D_FF),
        'g_ffn_post': gain(ks[15], (DEPTH, D_MODEL)),
    }


def reference(x, positions, g_mix_pre, w_in, b_forget, g_q_lora, w_q_up, g_kv_lora, w_kv_up,
              g_mix_out, w_out, g_mix_post, g_ffn_pre, w_ffn_up, w_ffn_down, g_ffn_post):
    for layer in range(DEPTH):
        h = rms_norm(x, g_mix_pre[layer])
        mix = hybrid_mixer(h, positions, w_in[layer], b_forget[layer], g_q_lora[layer], w_q_up[layer],
                           g_kv_lora[layer], w_kv_up[layer], g_mix_out[layer], w_out[layer])
        x = x + rms_norm(mix, g_mix_post[layer])
        h = rms_norm(x, g_ffn_pre[layer])
        x = x + rms_norm(squared_relu_mlp(h, w_ffn_up[layer], w_ffn_down[layer]), g_ffn_post[layer])
    return x
```

```cpp
#include <hip/hip_runtime.h>
#include <hip/hip_cooperative_groups.h>
#include <cstdio>
#include <cstdint>
namespace cg = cooperative_groups;

#define LAS __attribute__((address_space(3)))
typedef unsigned short bf16_t;
typedef short bf16x8 __attribute__((ext_vector_type(8)));
typedef float f32x4 __attribute__((ext_vector_type(4)));
typedef float f32x16 __attribute__((ext_vector_type(16)));
typedef unsigned u32x4 __attribute__((ext_vector_type(4)));
typedef unsigned u32x2 __attribute__((ext_vector_type(2)));
typedef float f32x2_t __attribute__((ext_vector_type(2)));
typedef __bf16 bf16x2_t __attribute__((ext_vector_type(2)));

constexpr int BATCH = 8, SEQ = 4096, DM = 1024, T = BATCH * SEQ, NP = 4096  , FF = 4096, DEPTH = 2;
constexpr int WIN_N = 2980;
constexpr float EPS = 1e-6f;
constexpr float LOG2E = 1.4426950408889634f;

constexpr int C_FQ = 0, C_FK = 256, C_FV = 512, C_MQ = 768, C_MKV = 1152, C_KR = 1664, C_FF = 1696, C_CQ = 1792, C_CKV = 2048,
              C_RQ = 2304, C_RK = 2560, C_RV = 2816, C_RG = 3072, C_SQ = 3328, C_SK = 3584, C_SV = 3840;
constexpr int S_FQ = 0, S_FK = 256, S_FV = 512, S_FF = 768, S_CQ = 772, S_CKV = 1028, S_KR = 1156, S_RQ = 1188, S_RK = 1444, S_RV = 1700,
              S_RG = 1956, S_SQ = 2212, S_SK = 2468, S_SV = 2724;

constexpr size_t MiB = 1u << 20;
constexpr size_t WS_CTL = 0, WS_WIN = 1 * MiB, WS_WOUT = 17 * MiB, WS_WUP = 21 * MiB, WS_WDN = 37 * MiB, WS_FL = 53 * MiB,
                 WS_H = 54 * MiB, WS_MIX = 118 * MiB, WS_PROJ = 182 * MiB, WS_END = 438 * MiB;
constexpr int LDS_BYTES = 131072;

struct Params {
    const float* x; const int* pos; const float* g_mix_pre; const float* w_in; const float* b_forget; const float* g_q; const float* w_q_up;
    const float* g_kv; const float* w_kv_up; const float* g_mix_out; const float* w_out; const float* g_mix_post; const float* g_ffn_pre;
    const float* w_up; const float* w_down; const float* g_ffn_post;
    float* out; unsigned char* ws;
};

__device__ __forceinline__ unsigned pk2(float lo, float hi) { f32x2_t v = {lo, hi}; bf16x2_t b = __builtin_convertvector(v, bf16x2_t); return __builtin_bit_cast(unsigned, b); }
__device__ __forceinline__ float bflo(unsigned u) { return __uint_as_float(u << 16); }
__device__ __forceinline__ float bfhi(unsigned u) { return __uint_as_float(u & 0xffff0000u); }
__device__ __forceinline__ float wave_sum(float v) {
#pragma unroll
    for (int o = 1; o < 64; o <<= 1) v += __shfl_xor(v, o);
    return v;
}
__device__ __forceinline__ float ex2(float x) { return __builtin_amdgcn_exp2f(x); }
__device__ __forceinline__ float lg2(float x) { return __builtin_amdgcn_logf(x); }
namespace pg8 {
#define PG8_LAS __attribute__((address_space(3)))
typedef unsigned short bf16_t;
typedef short bf16x8 __attribute__((ext_vector_type(8)));
typedef float f32x4 __attribute__((ext_vector_type(4)));
typedef unsigned u32x4 __attribute__((ext_vector_type(4)));
constexpr int BM = 256, BK = 64, HALF = 128, HTB = HALF * BK * 2  , STAGE_BYTES = 8 * HTB, NXCD = 8, WGM = 8;

__host__ __device__ __forceinline__ int lds_byte(int r, int c) { const int st = (r >> 4) * 2 + (c >> 5), rr = r & 15, cc = c & 31, ob = rr * 64 + cc * 2; return st * 1024 + (ob ^ (((ob >> 9) & 1) << 5)); }
__host__ __device__ __forceinline__ void stage_rc(int b, int& R, int& C) { const int st = b / 1024, sb = b % 1024, swz = sb ^ (((sb >> 9) & 1) << 5); R = (st >> 1) * 16 + swz / 64; C = (st & 1) * 32 + (swz % 64) / 2; }
__host__ __device__ __forceinline__ int perm32(int rho) { const int n = rho >> 4, i = rho & 15; return 8 * (i >> 2) + 4 * n + (i & 3); }

struct Unit { int pm, pn; };
struct Gemm { const bf16_t* A; const bf16_t* Bt; int M, N, K; };

struct StaticOrder {
    int nM, nN, nwg, G, c;
    __host__ __device__ void init(int M, int N, int G_, int c_) { nM = M / BM; nN = N / BM; nwg = nM * nN; G = G_; c = c_; }
    __host__ __device__ bool next(int i, Unit& u) const {
        const long L = (long)i * G + c; if (L >= nwg) return false;
        int wgid = (int)L; { const int q = nwg / NXCD, r = nwg % NXCD, xcd = wgid % NXCD, off = wgid / NXCD; wgid = (xcd < r ? xcd * (q + 1) : r * (q + 1) + (xcd - r) * q) + off; }
        const int nig = WGM * nN, gid = wgid / nig, fm = gid * WGM, gsz = (nM - fm) < WGM ? (nM - fm) : WGM;
        u.pm = fm + ((wgid % nig) % gsz); u.pn = (wgid % nig) / gsz; return true;
    }
    __device__ __forceinline__ void a_ready(const Unit&) const {}
    __device__ __forceinline__ void done(const Unit&) const {}
};

__device__ __forceinline__ unsigned cvt_pk_bf16(float lo, float hi) { unsigned r; asm volatile("v_cvt_pk_bf16_f32 %0, %1, %2" : "=v"(r) : "v"(lo), "v"(hi)); return r; }
template <int ACT  > struct EpiBf16 {
    static constexpr bool PERM = true, AFTER_DRAIN = false;
    bf16_t* O; int ldc;
    __device__ __forceinline__ void operator()(const f32x4 (&acc)[2][2][4][2], const Unit& u, int wr, int wc, int fr, int fq) const {
        const int row0 = u.pm * BM + wr * 64 + fr; const int col0 = u.pn * BM + wc * 32 + 8 * fq;
#pragma unroll
        for (int ai = 0; ai < 2; ++ai)
#pragma unroll
            for (int m = 0; m < 4; ++m) { bf16_t* rowp = O + (size_t)(row0 + ai * HALF + m * 16) * ldc + col0;
#pragma unroll
                for (int bj = 0; bj < 2; ++bj) { f32x4 v0 = acc[ai][bj][m][0], v1 = acc[ai][bj][m][1];
                    if (ACT == 1) {
#pragma unroll
                        for (int e = 0; e < 4; ++e) { const float a = __builtin_fmaxf(v0[e], 0.f), b = __builtin_fmaxf(v1[e], 0.f); v0[e] = a * a; v1[e] = b * b; } }
                    u32x4 w; w.x = cvt_pk_bf16(v0[0], v0[1]); w.y = cvt_pk_bf16(v0[2], v0[3]); w.z = cvt_pk_bf16(v1[0], v1[1]); w.w = cvt_pk_bf16(v1[2], v1[3]);
                    *(u32x4*)(rowp + bj * HALF) = w; } }
    }
};

template <class Epi, class Sched, bool ALIGN_EPI = false, bool SP2 = false>
__device__ __forceinline__ void gemm_phase(PG8_LAS unsigned char* lds, const Gemm g, const Sched& S, const Epi& E) {
    int tid_l = threadIdx.x; asm volatile("" : "+v"(tid_l));
    const int tid = tid_l, wid = __builtin_amdgcn_readfirstlane(tid >> 6), lane = tid & 63, wr = wid >> 2, wc = wid & 3, fr = lane & 15, fq = lane >> 4;
    const int K = g.K, nt = K / BK;
    unsigned voffA[2], voffB[2];
#pragma unroll
    for (int i = 0; i < 2; ++i) { int R, C; stage_rc(tid * 16 + i * 8192, R, C); const int Rb = Epi::PERM ? ((R & ~31) + perm32(R & 31)) : R;
        voffA[i] = (unsigned)(R * K + C) * 2u; voffB[i] = (unsigned)(Rb * K + C) * 2u; }
    const size_t kstep = (size_t)(BK * 2);
    const size_t hstep = (size_t)HALF * K * 2;
    const size_t tstep = 2 * hstep;
    const unsigned ldsw = (unsigned)wid * 1024u;
    const int aoff = lds_byte(wr * 64 + fr, fq * 8), boff = lds_byte(wc * 32 + fr, fq * 8);
#define PG8_SA(b, h) (((b) * 2 + (h)) * HTB)
#define PG8_SB(b, h) ((4 + (b) * 2 + (h)) * HTB)
#define PG8_STAGE(bufoff, gbase, voff) do { _Pragma("unroll") for (int _i = 0; _i < 2; ++_i) \
        __builtin_amdgcn_global_load_lds((const unsigned*)((const char*)(gbase) + (voff)[_i]), (PG8_LAS unsigned*)(lds + (bufoff) + ldsw + _i * 8192), 16, 0, 0); } while (0)
#define PG8_LDA(dst, b, h) do { _Pragma("unroll") for (int m = 0; m < 4; ++m) _Pragma("unroll") for (int k = 0; k < 2; ++k) dst[m][k] = *(const PG8_LAS bf16x8*)(lds + PG8_SA(b, h) + aoff + m * 2048 + k * 1024); } while (0)
#define PG8_LDB(dst, b, h) do { _Pragma("unroll") for (int n = 0; n < 2; ++n) _Pragma("unroll") for (int k = 0; k < 2; ++k) dst[n][k] = *(const PG8_LAS bf16x8*)(lds + PG8_SB(b, h) + boff + n * 2048 + k * 1024); } while (0)
#define PG8_MMA(ai, bj, At, Bt) do { __builtin_amdgcn_s_setprio(1); _Pragma("unroll") for (int m = 0; m < 4; ++m) _Pragma("unroll") for (int n = 0; n < 2; ++n) _Pragma("unroll") for (int k = 0; k < 2; ++k) \
        acc[ai][bj][m][n] = __builtin_amdgcn_mfma_f32_16x16x32_bf16(Bt[n][k], At[m][k], acc[ai][bj][m][n], 0, 0, 0); __builtin_amdgcn_s_setprio(0); } while (0)
#define PG8_WAIT_V(n) asm volatile("s_waitcnt vmcnt(" #n ")" ::: "memory")
#define PG8_WAIT_L(n) asm volatile("s_waitcnt lgkmcnt(" #n ")" ::: "memory")
#define PG8_BAR __builtin_amdgcn_s_barrier()
#define PG8_SCHED __builtin_amdgcn_sched_barrier(0)
    Unit cur, nxt; int ui = 0;
    if (!S.next(0, cur)) return;
    f32x4 acc[2][2][4][2];
#pragma unroll
    for (int a = 0; a < 2; ++a)
#pragma unroll
        for (int b = 0; b < 2; ++b)
#pragma unroll
            for (int m = 0; m < 4; ++m)
#pragma unroll
                for (int n = 0; n < 2; ++n) acc[a][b][m][n] = (f32x4){0.f, 0.f, 0.f, 0.f};
    bf16x8 At[4][2], B0[2][2], B1[2][2];
    const char* cA = (const char*)g.A + (size_t)cur.pm * tstep; const char* cB = (const char*)g.Bt + (size_t)cur.pn * tstep;
    S.a_ready(cur);
    if constexpr (SP2) {
        PG8_STAGE(PG8_SB(0, 0), cB, voffB); PG8_STAGE(PG8_SB(0, 1), cB + hstep, voffB); PG8_STAGE(PG8_SA(0, 0), cA, voffA); PG8_STAGE(PG8_SA(0, 1), cA + hstep, voffA);
        if (wr == 1) PG8_BAR;
        PG8_WAIT_V(2); PG8_BAR;
        PG8_STAGE(PG8_SB(1, 0), cB + kstep, voffB); PG8_STAGE(PG8_SA(1, 0), cA + kstep, voffA); PG8_STAGE(PG8_SB(1, 1), cB + hstep + kstep, voffB);
        PG8_WAIT_V(6); PG8_BAR;
    } else {
        PG8_STAGE(PG8_SB(0, 0), cB, voffB); PG8_STAGE(PG8_SA(0, 0), cA, voffA); PG8_STAGE(PG8_SB(0, 1), cB + hstep, voffB); PG8_STAGE(PG8_SA(0, 1), cA + hstep, voffA);
        if (wr == 1) PG8_BAR;
        PG8_WAIT_V(4); PG8_BAR;
        PG8_STAGE(PG8_SB(1, 0), cB + kstep, voffB); PG8_STAGE(PG8_SA(1, 0), cA + kstep, voffA); PG8_STAGE(PG8_SB(1, 1), cB + hstep + kstep, voffB);
        PG8_WAIT_V(6); PG8_BAR;
    }
    for (;;) {
        const bool has_next = S.next(ui + 1, nxt);
        const char* nA = has_next ? (const char*)g.A + (size_t)nxt.pm * tstep : cA; const char* nB = has_next ? (const char*)g.Bt + (size_t)nxt.pn * tstep : cB;
        for (int t = 0; t < nt; t += 2) {
            const bool last = (t == nt - 2);
            const char* a1 = cA + (size_t)(t + 1) * kstep;
            const char* a2 = last ? nA : cA + (size_t)(t + 2) * kstep; const char* b2 = last ? nB : cB + (size_t)(t + 2) * kstep;
            const char* a3 = a2 + kstep; const char* b3 = b2 + kstep;
            if (last && has_next) S.a_ready(nxt);
            if constexpr (SP2) {
            PG8_LDB(B0, 0, 0); PG8_LDB(B1, 0, 1); PG8_SCHED; PG8_LDA(At, 0, 0); PG8_STAGE(PG8_SA(1, 1), a1 + hstep, voffA);
            PG8_WAIT_V(8); PG8_WAIT_L(0); PG8_BAR; PG8_MMA(0, 0, At, B0); PG8_MMA(0, 1, At, B1); PG8_BAR; PG8_SCHED;
            PG8_LDA(At, 0, 1); PG8_STAGE(PG8_SB(0, 0), b2, voffB); PG8_STAGE(PG8_SB(0, 1), b2 + hstep, voffB); PG8_STAGE(PG8_SA(0, 0), a2, voffA);
            PG8_WAIT_V(8); PG8_WAIT_L(0); PG8_BAR; PG8_MMA(1, 0, At, B0); PG8_MMA(1, 1, At, B1); PG8_BAR; PG8_SCHED;
            PG8_LDB(B0, 1, 0); PG8_LDB(B1, 1, 1); PG8_SCHED; PG8_LDA(At, 1, 0); PG8_STAGE(PG8_SA(0, 1), a2 + hstep, voffA);
            PG8_WAIT_V(8); PG8_WAIT_L(0); PG8_BAR; PG8_MMA(0, 0, At, B0); PG8_MMA(0, 1, At, B1); PG8_BAR; PG8_SCHED;
            PG8_LDA(At, 1, 1); PG8_STAGE(PG8_SB(1, 0), b3, voffB); PG8_STAGE(PG8_SB(1, 1), b3 + hstep, voffB); PG8_STAGE(PG8_SA(1, 0), a3, voffA);
            PG8_WAIT_V(8); PG8_WAIT_L(0); PG8_BAR; PG8_MMA(1, 0, At, B0); PG8_MMA(1, 1, At, B1); PG8_BAR; PG8_SCHED;
            } else {
            PG8_LDB(B0, 0, 0); PG8_SCHED; PG8_LDA(At, 0, 0); PG8_STAGE(PG8_SA(1, 1), a1 + hstep, voffA);
            PG8_WAIT_L(8); PG8_BAR; PG8_WAIT_L(0); PG8_MMA(0, 0, At, B0); PG8_BAR; PG8_SCHED;
            PG8_LDB(B1, 0, 1); PG8_STAGE(PG8_SB(0, 0), b2, voffB);
            PG8_BAR; PG8_WAIT_L(0); PG8_MMA(0, 1, At, B1); PG8_BAR;
            PG8_LDA(At, 0, 1); PG8_STAGE(PG8_SA(0, 0), a2, voffA);
            PG8_BAR; PG8_WAIT_L(0); PG8_MMA(1, 0, At, B0); PG8_BAR; PG8_SCHED;
            PG8_STAGE(PG8_SB(0, 1), b2 + hstep, voffB);
            PG8_WAIT_V(6); PG8_BAR; PG8_MMA(1, 1, At, B1); PG8_BAR;
            PG8_LDB(B0, 1, 0); PG8_SCHED; PG8_LDA(At, 1, 0); PG8_STAGE(PG8_SA(0, 1), a2 + hstep, voffA);
            PG8_WAIT_L(8); PG8_BAR; PG8_WAIT_L(0); PG8_MMA(0, 0, At, B0); PG8_BAR; PG8_SCHED;
            PG8_LDB(B1, 1, 1); PG8_STAGE(PG8_SB(1, 0), b3, voffB);
            PG8_BAR; PG8_WAIT_L(0); PG8_MMA(0, 1, At, B1); PG8_BAR;
            PG8_LDA(At, 1, 1); PG8_STAGE(PG8_SA(1, 0), a3, voffA);
            PG8_BAR; PG8_WAIT_L(0); PG8_MMA(1, 0, At, B0); PG8_BAR; PG8_SCHED;
            PG8_STAGE(PG8_SB(1, 1), b3 + hstep, voffB);
            PG8_WAIT_V(6); PG8_BAR; PG8_MMA(1, 1, At, B1); PG8_BAR;
            }
        }
        if constexpr (ALIGN_EPI) { if (wr == 0) PG8_BAR; }
        if constexpr (!Epi::AFTER_DRAIN) { E(acc, cur, wr, wc, fr, fq); S.done(cur); }
        if (!has_next) break;
#pragma unroll
        for (int a = 0; a < 2; ++a)
#pragma unroll
            for (int b = 0; b < 2; ++b)
#pragma unroll
                for (int m = 0; m < 4; ++m)
#pragma unroll
                    for (int n = 0; n < 2; ++n) acc[a][b][m][n] = (f32x4){0.f, 0.f, 0.f, 0.f};
        cur = nxt; cA = nA; cB = nB; ++ui;
        if constexpr (ALIGN_EPI) { if (wr == 1) PG8_BAR; }
    }
    PG8_WAIT_V(0);
    if constexpr (!ALIGN_EPI) { if (wr == 0) PG8_BAR; }
    PG8_BAR;
    if constexpr (Epi::AFTER_DRAIN) { E.fused(acc, cur, wr, wc, fr, fq, lds, wid, lane); S.done(cur); }
#undef PG8_SA
#undef PG8_SB
#undef PG8_STAGE
#undef PG8_LDA
#undef PG8_LDB
#undef PG8_MMA
#undef PG8_WAIT_V
#undef PG8_WAIT_L
#undef PG8_BAR
#undef PG8_SCHED
}
}
namespace att {
constexpr int KB_BYTES = 64 * 208, VB_BYTES = 64 * 144;
constexpr int OFF_K0 = 0, OFF_K1 = KB_BYTES, OFF_V0 = 2 * KB_BYTES, OFF_V1 = 2 * KB_BYTES + VB_BYTES;
constexpr int OFF_WS = 2 * KB_BYTES + 2 * VB_BYTES;
constexpr int OFF_CUM = OFF_WS + 8 * 256;
constexpr int OFF_MISC = OFF_CUM + 16384;
constexpr int LDS_NEED = OFF_MISC + 256;
static_assert(LDS_NEED <= LDS_BYTES, "attention LDS");

#define MFMA32(a, b, c) __builtin_amdgcn_mfma_f32_32x32x16_bf16((a), (b), (c), 0, 0, 0)

template <int VAR>
__device__ __forceinline__ void attn_unit(const bf16_t* __restrict__ proj, const float* __restrict__ fl, bf16_t* __restrict__ mixed, int b, int h, int qb, LAS unsigned char* lds) {
    constexpr int DK = (VAR == 1) ? 96 : 64, ND = DK / 16, KSTR = DK * 2 + 16;
    constexpr int QCOL = VAR == 0 ? C_FQ : VAR == 1 ? C_MQ : VAR == 2 ? C_RQ : C_SQ, QHS = VAR == 1 ? 96 : 64;
    constexpr int KCOL = VAR == 0 ? C_FK : VAR == 1 ? C_MKV : VAR == 2 ? C_RK : C_SK, KHS = VAR == 1 ? 128 : 64;
    constexpr int VCOL = VAR == 0 ? C_FV : VAR == 1 ? (C_MKV + 64) : VAR == 2 ? C_RV : C_SV, VHS = KHS;
    constexpr int OGRP = VAR == 0 ? 0 : VAR == 1 ? 1 : VAR == 2 ? 2 : 3;
    int tid_l = threadIdx.x; asm volatile("" : "+v"(tid_l));
    const int tid = tid_l, lane = tid & 63, wid = __builtin_amdgcn_readfirstlane(tid >> 6), r32 = lane & 31, hi = lane >> 5;
    const size_t rowbase = (size_t)b * SEQ;
    const int q0 = qb * 256, qw = q0 + wid * 32;
    const int NT = (q0 + 256) / 64;
    const bf16_t* Kg = proj + rowbase * NP + KCOL + h * KHS;
    const bf16_t* Vg = proj + rowbase * NP + VCOL + h * VHS;
    const bf16_t* K2g = proj + rowbase * NP + C_KR;
    const int lk_key = tid >> 3, lk_ch = tid & 7, lk2_key = (tid >> 2) & 63, lk2_ch = tid & 3, lv_key = tid & 63, lv_dc = tid >> 6;
    const int vpos = 16 * (lv_key >> 4) + 8 * ((lv_key >> 2) & 1) + 4 * ((lv_key >> 3) & 1) + (lv_key & 3);
    LAS float* wscr = (LAS float*)(lds + OFF_WS) + wid * 64;
    LAS float* cum = (LAS float*)(lds + OFF_CUM);

    if (VAR == 0) {
        LAS float* part = (LAS float*)(lds + OFF_MISC + 64);
        const int s0 = tid * 8; float v[8]; float run = 0.f;
#pragma unroll
        for (int i = 0; i < 8; ++i) { const int s = s0 + i; const float f = (s < NT * 64) ? fl[(rowbase + s) * 4 + h] : 0.f; run += f; v[i] = run; }
        float inc = run;
#pragma unroll
        for (int o = 1; o < 64; o <<= 1) { const float tt = __shfl_up(inc, o); if (lane >= o) inc += tt; }
        if (lane == 63) part[wid] = inc;
        __syncthreads();
        float base = inc - run;
#pragma unroll
        for (int w = 0; w < 8; ++w) if (w < wid) base += part[w];
#pragma unroll
        for (int i = 0; i < 8; ++i) cum[s0 + i] = v[i] + base;
    }
    float lgam = 0.f;
    if (VAR == 2) lgam = log2f(1.0f - exp2f(-5.0f - (float)h));

    bf16x8 qr[ND];
    { const bf16_t* Qg = proj + (rowbase + qw + r32) * NP + QCOL + h * QHS + hi * 8;
#pragma unroll
      for (int d0 = 0; d0 < ND; ++d0) qr[d0] = *(const bf16x8*)(Qg + d0 * 16); }

    u32x4 kreg, k2reg = {0u, 0u, 0u, 0u}, vreg;
#define ATT_TILE(i) ((VAR == 3) ? (NT - 1 - (i)) : (i))
#define ATT_GLOAD(t) do { const size_t r_ = (size_t)(t) * 64; \
        kreg = *(const u32x4*)(Kg + (r_ + lk_key) * NP + lk_ch * 8); \
        if (VAR == 1) { if (tid < 256) k2reg = *(const u32x4*)(K2g + (r_ + lk2_key) * NP + lk2_ch * 8); } \
        vreg = *(const u32x4*)(Vg + (r_ + lv_key) * NP + lv_dc * 8); } while (0)
#define ATT_LSTORE(buf) do { LAS unsigned char* kb_ = lds + ((buf) ? OFF_K1 : OFF_K0); LAS unsigned char* vb_ = lds + ((buf) ? OFF_V1 : OFF_V0); \
        *(LAS u32x4*)(kb_ + lk_key * KSTR + lk_ch * 16) = kreg; \
        if (VAR == 1) { if (tid < 256) *(LAS u32x4*)(kb_ + lk2_key * KSTR + 128 + lk2_ch * 16) = k2reg; } \
        LAS unsigned short* vt_ = (LAS unsigned short*)(vb_ + (lv_dc * 8) * 144 + vpos * 2); \
        vt_[0 * 72] = (unsigned short)(vreg.x & 0xffffu); vt_[1 * 72] = (unsigned short)(vreg.x >> 16); \
        vt_[2 * 72] = (unsigned short)(vreg.y & 0xffffu); vt_[3 * 72] = (unsigned short)(vreg.y >> 16); \
        vt_[4 * 72] = (unsigned short)(vreg.z & 0xffffu); vt_[5 * 72] = (unsigned short)(vreg.z >> 16); \
        vt_[6 * 72] = (unsigned short)(vreg.w & 0xffffu); vt_[7 * 72] = (unsigned short)(vreg.w >> 16); } while (0)

    ATT_GLOAD(ATT_TILE(0)); ATT_LSTORE(0); __syncthreads();
    float m_run = -INFINITY, l_run = 0.f, carry = 0.f;
    f32x16 o0, o1;
#pragma unroll
    for (int r = 0; r < 16; ++r) { o0[r] = 0.f; o1[r] = 0.f; }

    for (int i = 0; i < NT; ++i) {
        const int t = ATT_TILE(i); const int buf = i & 1;
        if (i + 1 < NT) ATT_GLOAD(ATT_TILE(i + 1));
        bool active, need_mask = false;
        if (VAR == 0) { active = (64 * t <= qw + 31); need_mask = (64 * t + 63 > qw); }
        else if (VAR == 3) { active = (64 * t <= qw + 30); need_mask = (64 * t + 63 >= qw); }
        else active = (64 * t <= qw);
        if (active) {
            LAS const unsigned char* kb = lds + (buf ? OFF_K1 : OFF_K0) + r32 * KSTR + hi * 16;
            LAS const unsigned char* vb = lds + (buf ? OFF_V1 : OFF_V0) + r32 * 144 + hi * 16;
            f32x16 p0, p1;
            if (VAR == 0) {
                LAS const float* cb = cum + t * 64 + 4 * hi;
#pragma unroll
                for (int j = 0; j < 4; ++j) { const f32x4 c0 = *(LAS const f32x4*)(cb + 8 * j), c1 = *(LAS const f32x4*)(cb + 32 + 8 * j);
#pragma unroll
                    for (int e = 0; e < 4; ++e) { p0[4 * j + e] = -c0[e]; p1[4 * j + e] = -c1[e]; } }
            } else {
#pragma unroll
                for (int r = 0; r < 16; ++r) { p0[r] = 0.f; p1[r] = 0.f; }
            }
#pragma unroll
            for (int d0 = 0; d0 < ND; ++d0) {
                const bf16x8 a0 = *(LAS const bf16x8*)(kb + d0 * 32), a1 = *(LAS const bf16x8*)(kb + 32 * KSTR + d0 * 32);
                p0 = MFMA32(a0, qr[d0], p0); p1 = MFMA32(a1, qr[d0], p1);
            }
            if (VAR == 0 || VAR == 1) {
                if (VAR == 0 && need_mask) { const int qa = qw + r32, kb0 = 64 * t + 4 * hi;
#pragma unroll
                    for (int r = 0; r < 16; ++r) { const int kv = kb0 + (r & 3) + 8 * (r >> 2); if (kv > qa) p0[r] = -INFINITY; if (kv + 32 > qa) p1[r] = -INFINITY; } }
                float rm = __builtin_fmaxf(p0[0], p1[0]);
#pragma unroll
                for (int r = 1; r < 16; ++r) rm = __builtin_fmaxf(rm, __builtin_fmaxf(p0[r], p1[r]));
                rm = __builtin_fmaxf(rm, __shfl_xor(rm, 32));
                const float mn = __builtin_fmaxf(m_run, rm); const float alpha = ex2(m_run - mn); m_run = mn;
                float rs = 0.f;
#pragma unroll
                for (int r = 0; r < 16; ++r) { p0[r] = ex2(p0[r] - mn); p1[r] = ex2(p1[r] - mn); rs += p0[r] + p1[r]; }
                l_run = l_run * alpha + rs;
                if (__any(alpha != 1.0f)) {
                    __builtin_amdgcn_wave_barrier();
                    if (hi == 0) wscr[r32] = alpha;
                    __builtin_amdgcn_wave_barrier();
#pragma unroll
                    for (int j = 0; j < 4; ++j) { const f32x4 a4 = *(LAS const f32x4*)(wscr + 8 * j + 4 * hi);
#pragma unroll
                        for (int e = 0; e < 4; ++e) { o0[4 * j + e] *= a4[e]; o1[4 * j + e] *= a4[e]; } }
                    __builtin_amdgcn_wave_barrier();
                }
            } else if (VAR == 2) {
                const int dq = qw + r32 - 64 * t - 4 * hi;
#pragma unroll
                for (int r = 0; r < 16; ++r) { const int dd = dq - ((r & 3) + 8 * (r >> 2));
                    p0[r] *= ex2(lgam * __builtin_fabsf((float)dd)); p1[r] *= ex2(lgam * __builtin_fabsf((float)(dd - 32))); }
            } else {
                if (need_mask) { const int qa = qw + r32, kb0 = 64 * t + 4 * hi;
#pragma unroll
                    for (int r = 0; r < 16; ++r) { const int kv = kb0 + (r & 3) + 8 * (r >> 2); if (kv >= qa) p0[r] = -INFINITY; if (kv + 32 >= qa) p1[r] = -INFINITY; } }
                f32x16 l0, l1;
#pragma unroll
                for (int r = 0; r < 16; ++r) {
                    const float z0 = p0[r], z1 = p1[r];
                    l0[r] = -(__builtin_fmaxf(z0, 0.f) + lg2(1.0f + ex2(-__builtin_fabsf(z0))));
                    l1[r] = -(__builtin_fmaxf(z1, 0.f) + lg2(1.0f + ex2(-__builtin_fabsf(z1))));
                }
                float cs0[4], cs1[4], pc0[4], pc1[4];
#pragma unroll
                for (int j = 0; j < 4; ++j) { cs0[j] = (l0[4 * j] + l0[4 * j + 1]) + (l0[4 * j + 2] + l0[4 * j + 3]); cs1[j] = (l1[4 * j] + l1[4 * j + 1]) + (l1[4 * j + 2] + l1[4 * j + 3]); }
#pragma unroll
                for (int j = 0; j < 4; ++j) { pc0[j] = __shfl_xor(cs0[j], 32); pc1[j] = __shfl_xor(cs1[j], 32); }
                float run = carry;
#pragma unroll
                for (int j = 3; j >= 0; --j) { const float X = run + (hi == 0 ? pc1[j] : 0.f);
                    const float s3 = l1[4 * j + 3] + X, s2 = l1[4 * j + 2] + s3, s1 = l1[4 * j + 1] + s2, s0 = l1[4 * j] + s1;
                    p1[4 * j + 3] = ex2(p1[4 * j + 3] + s3); p1[4 * j + 2] = ex2(p1[4 * j + 2] + s2); p1[4 * j + 1] = ex2(p1[4 * j + 1] + s1); p1[4 * j] = ex2(p1[4 * j] + s0);
                    run += cs1[j] + pc1[j]; }
#pragma unroll
                for (int j = 3; j >= 0; --j) { const float X = run + (hi == 0 ? pc0[j] : 0.f);
                    const float s3 = l0[4 * j + 3] + X, s2 = l0[4 * j + 2] + s3, s1 = l0[4 * j + 1] + s2, s0 = l0[4 * j] + s1;
                    p0[4 * j + 3] = ex2(p0[4 * j + 3] + s3); p0[4 * j + 2] = ex2(p0[4 * j + 2] + s2); p0[4 * j + 1] = ex2(p0[4 * j + 1] + s1); p0[4 * j] = ex2(p0[4 * j] + s0);
                    run += cs0[j] + pc0[j]; }
                carry = run;
            }
            u32x4 w0, w1, w2, w3;
            w0.x = pk2(p0[0], p0[1]); w0.y = pk2(p0[2], p0[3]); w0.z = pk2(p0[4], p0[5]); w0.w = pk2(p0[6], p0[7]);
            w1.x = pk2(p0[8], p0[9]); w1.y = pk2(p0[10], p0[11]); w1.z = pk2(p0[12], p0[13]); w1.w = pk2(p0[14], p0[15]);
            w2.x = pk2(p1[0], p1[1]); w2.y = pk2(p1[2], p1[3]); w2.z = pk2(p1[4], p1[5]); w2.w = pk2(p1[6], p1[7]);
            w3.x = pk2(p1[8], p1[9]); w3.y = pk2(p1[10], p1[11]); w3.z = pk2(p1[12], p1[13]); w3.w = pk2(p1[14], p1[15]);
            const bf16x8 pa0 = __builtin_bit_cast(bf16x8, w0), pa1 = __builtin_bit_cast(bf16x8, w1), pa2 = __builtin_bit_cast(bf16x8, w2), pa3 = __builtin_bit_cast(bf16x8, w3);
            { const bf16x8 b0 = *(LAS const bf16x8*)(vb + 0), b1 = *(LAS const bf16x8*)(vb + 32 * 144 + 0); o0 = MFMA32(pa0, b0, o0); o1 = MFMA32(pa0, b1, o1); }
            { const bf16x8 b0 = *(LAS const bf16x8*)(vb + 32), b1 = *(LAS const bf16x8*)(vb + 32 * 144 + 32); o0 = MFMA32(pa1, b0, o0); o1 = MFMA32(pa1, b1, o1); }
            { const bf16x8 b0 = *(LAS const bf16x8*)(vb + 64), b1 = *(LAS const bf16x8*)(vb + 32 * 144 + 64); o0 = MFMA32(pa2, b0, o0); o1 = MFMA32(pa2, b1, o1); }
            { const bf16x8 b0 = *(LAS const bf16x8*)(vb + 96), b1 = *(LAS const bf16x8*)(vb + 32 * 144 + 96); o0 = MFMA32(pa3, b0, o0); o1 = MFMA32(pa3, b1, o1); }
        }
        if (i + 1 < NT) ATT_LSTORE(buf ^ 1);
        __syncthreads();
    }
    if (VAR == 0 || VAR == 1) {
        const float lt = l_run + __shfl_xor(l_run, 32); const float inv = 1.0f / lt;
        __builtin_amdgcn_wave_barrier();
        if (hi == 0) wscr[r32] = inv;
        __builtin_amdgcn_wave_barrier();
#pragma unroll
        for (int j = 0; j < 4; ++j) { const f32x4 a4 = *(LAS const f32x4*)(wscr + 8 * j + 4 * hi);
#pragma unroll
            for (int e = 0; e < 4; ++e) { o0[4 * j + e] *= a4[e]; o1[4 * j + e] *= a4[e]; } }
        __builtin_amdgcn_wave_barrier();
    }
    { bf16_t* Og = mixed + (rowbase + qw) * DM + OGRP * 256 + h * 64 + r32;
#pragma unroll
      for (int r = 0; r < 16; ++r) { const int row = (r & 3) + 8 * (r >> 2) + 4 * hi;
          Og[(size_t)row * DM] = (bf16_t)(pk2(o0[r], 0.f) & 0xffffu); Og[(size_t)row * DM + 32] = (bf16_t)(pk2(o1[r], 0.f) & 0xffffu); } }
#undef ATT_TILE
#undef ATT_GLOAD
#undef ATT_LSTORE
}

__device__ __forceinline__ void attn_phase(const bf16_t* proj, const float* fl, bf16_t* mixed, unsigned* counter, LAS unsigned char* lds) {
    LAS volatile unsigned* misc = (LAS volatile unsigned*)(lds + OFF_MISC);
    for (;;) {
        if (threadIdx.x == 0) misc[0] = atomicAdd(counter, 1u);
        __syncthreads();
        const int u = __builtin_amdgcn_readfirstlane((int)misc[0]);
        __syncthreads();
        if (u >= 2048) break;
        const int qb = 15 - (u >> 7), v = u & 127, vo = v >> 5, bh = v & 31, b = bh >> 2, h = bh & 3;
        if (vo == 0) attn_unit<3>(proj, fl, mixed, b, h, qb, lds);
        else if (vo == 1) attn_unit<1>(proj, fl, mixed, b, h, qb, lds);
        else if (vo == 2) attn_unit<0>(proj, fl, mixed, b, h, qb, lds);
        else attn_unit<2>(proj, fl, mixed, b, h, qb, lds);
    }
}
}

__device__ __forceinline__ void rope_sc(float posf, float invf, float& s, float& c) {
    const float ang = posf * invf;
    const float k = rintf(ang * 0.15915494309189535f);
    float r = fmaf(-k, 6.2831854820251465f, ang);
    r = fmaf(-k, -1.7484555e-7f, r);
    s = __sinf(r); c = __cosf(r);
}

__device__ __forceinline__ void fixup_row(const int* pos, const float* b_forget, int row, int lane, bf16_t* proj, float* fl) {
    bf16_t* pr = proj + (size_t)row * NP;
    const float posf = (float)pos[row];
    constexpr float L2B = 13.287712379549449f;
    float s16[2], c16[2], s32[2], c32[2];
#pragma unroll
    for (int e = 0; e < 2; ++e) {
        const int i16 = ((2 * lane) & 15) + e, i32 = ((2 * lane) & 31) + e;
        rope_sc(posf, exp2f(-(float)i16 * (L2B / 16.0f)), s16[e], c16[e]);
        rope_sc(posf, exp2f(-(float)i32 * (L2B / 32.0f)), s32[e], c32[e]);
    }
    float rs_q, rs_kv;
    { const u32x2 v = *(const u32x2*)(pr + C_CQ + 4 * lane); const float a = bflo(v.x), b = bfhi(v.x), c = bflo(v.y), d = bfhi(v.y);
      rs_q = rsqrtf(wave_sum(a * a + b * b + c * c + d * d) * (1.0f / 256.0f) + EPS); }
    { const unsigned v = *(const unsigned*)(pr + C_CKV + 2 * lane); const float a = bflo(v), b = bfhi(v);
      rs_kv = rsqrtf(wave_sum(a * a + b * b) * (1.0f / 128.0f) + EPS); }
#pragma unroll
    for (int j = 0; j < 3; ++j) {
        const int e = 2 * lane + 128 * j;
        const unsigned v = *(const unsigned*)(pr + C_MQ + e);
        float x0 = bflo(v) * rs_q, x1 = bfhi(v) * rs_q;
        const float y0 = __shfl_xor(x0, 8), y1 = __shfl_xor(x1, 8);
        const int hd = (e >= 288) ? 3 : (e >= 192) ? 2 : (e >= 96) ? 1 : 0, d = e - 96 * hd;
        if (d >= 64) {
            if (((e >> 4) & 1) == 0) { x0 = x0 * c16[0] - y0 * s16[0]; x1 = x1 * c16[1] - y1 * s16[1]; }
            else { x0 = y0 * s16[0] + x0 * c16[0]; x1 = y1 * s16[1] + x1 * c16[1]; }
        }
        *(unsigned*)(pr + C_MQ + e) = pk2(x0, x1);
    }
    { u32x4 v = *(const u32x4*)(pr + C_MKV + 8 * lane);
      v.x = pk2(bflo(v.x) * rs_kv, bfhi(v.x) * rs_kv); v.y = pk2(bflo(v.y) * rs_kv, bfhi(v.y) * rs_kv);
      v.z = pk2(bflo(v.z) * rs_kv, bfhi(v.z) * rs_kv); v.w = pk2(bflo(v.w) * rs_kv, bfhi(v.w) * rs_kv);
      *(u32x4*)(pr + C_MKV + 8 * lane) = v; }
    { const int e = (2 * lane) & 31;
      const unsigned v = *(const unsigned*)(pr + C_KR + e);
      float x0 = bflo(v), x1 = bfhi(v);
      const float y0 = __shfl_xor(x0, 8), y1 = __shfl_xor(x1, 8);
      if (((e >> 4) & 1) == 0) { x0 = x0 * c16[0] - y0 * s16[0]; x1 = x1 * c16[1] - y1 * s16[1]; }
      else { x0 = y0 * s16[0] + x0 * c16[0]; x1 = y1 * s16[1] + x1 * c16[1]; }
      if (lane < 16) *(unsigned*)(pr + C_KR + e) = pk2(x0, x1); }
#pragma unroll
    for (int qk = 0; qk < 2; ++qk) {
        const int base = qk ? C_RK : C_RQ;
#pragma unroll
        for (int j = 0; j < 2; ++j) {
            const int e = 2 * lane + 128 * j;
            const unsigned v = *(const unsigned*)(pr + base + e);
            float x0 = bflo(v), x1 = bfhi(v);
            const float y0 = __shfl_xor(x0, 16), y1 = __shfl_xor(x1, 16);
            if (((e >> 5) & 1) == 0) { x0 = x0 * c32[0] - y0 * s32[0]; x1 = x1 * c32[1] - y1 * s32[1]; }
            else { x0 = y0 * s32[0] + x0 * c32[0]; x1 = y1 * s32[1] + x1 * c32[1]; }
            *(unsigned*)(pr + base + e) = pk2(x0, x1);
        }
    }
    if (lane < 4) {
        const float xx = __uint_as_float((unsigned)pr[C_FF + lane] << 16) + b_forget[lane];
        const float u = -xx * LOG2E;
        fl[(size_t)row * 4 + lane] = -(fmaxf(u, 0.f) + log2f(1.0f + exp2f(-fabsf(u))));
    }
}

__device__ __forceinline__ void mixnorm_row(const float* g, int row, int lane, bf16_t* mixed, const bf16_t* proj) {
    bf16_t* mr = mixed + (size_t)row * DM;
    const u32x4 va = *(const u32x4*)(mr + 8 * lane), vc = *(const u32x4*)(mr + 512 + 8 * lane);
    const u32x4 vg = *(const u32x4*)(proj + (size_t)row * NP + C_RG + 8 * (lane & 31));
    float a[8], c[8], gt[8];
    a[0] = bflo(va.x); a[1] = bfhi(va.x); a[2] = bflo(va.y); a[3] = bfhi(va.y); a[4] = bflo(va.z); a[5] = bfhi(va.z); a[6] = bflo(va.w); a[7] = bfhi(va.w);
    c[0] = bflo(vc.x); c[1] = bfhi(vc.x); c[2] = bflo(vc.y); c[3] = bfhi(vc.y); c[4] = bflo(vc.z); c[5] = bfhi(vc.z); c[6] = bflo(vc.w); c[7] = bfhi(vc.w);
    gt[0] = bflo(vg.x); gt[1] = bfhi(vg.x); gt[2] = bflo(vg.y); gt[3] = bfhi(vg.y); gt[4] = bflo(vg.z); gt[5] = bfhi(vg.z); gt[6] = bflo(vg.w); gt[7] = bfhi(vg.w);
    float ssa = 0.f, ssc = 0.f, sc = 0.f;
#pragma unroll
    for (int i = 0; i < 8; ++i) { ssa += a[i] * a[i]; ssc += c[i] * c[i]; sc += c[i]; }
#pragma unroll
    for (int o = 1; o < 32; o <<= 1) { ssa += __shfl_xor(ssa, o); ssc += __shfl_xor(ssc, o); }
#pragma unroll
    for (int o = 1; o < 8; o <<= 1) sc += __shfl_xor(sc, o);
    const float mean = sc * (1.0f / 64.0f);
    float dv = 0.f;
#pragma unroll
    for (int i = 0; i < 8; ++i) { const float d = c[i] - mean; dv += d * d; }
#pragma unroll
    for (int o = 1; o < 8; o <<= 1) dv += __shfl_xor(dv, o);
    const float rsa = rsqrtf(ssa * (1.0f / 256.0f) + EPS), rsc = rsqrtf(ssc * (1.0f / 256.0f) + EPS), rsv = rsqrtf(dv * (1.0f / 64.0f) + EPS);
    const f32x4 ga0 = *(const f32x4*)(g + 8 * lane), ga1 = *(const f32x4*)(g + 8 * lane + 4), gc0 = *(const f32x4*)(g + 512 + 8 * lane), gc1 = *(const f32x4*)(g + 512 + 8 * lane + 4);
    float oa[8], oc[8];
#pragma unroll
    for (int i = 0; i < 8; ++i) {
        const float ga = (i < 4) ? ga0[i & 3] : ga1[i & 3], gc = (i < 4) ? gc0[i & 3] : gc1[i & 3];
        oa[i] = a[i] * rsa * ga;
        if (lane < 32) { const float x = gt[i]; const float sl = x / (1.0f + __expf(-x)); oc[i] = (c[i] - mean) * rsv * gc * sl; }
        else oc[i] = c[i] * rsc * gc;
    }
    u32x4 wa, wc;
    wa.x = pk2(oa[0], oa[1]); wa.y = pk2(oa[2], oa[3]); wa.z = pk2(oa[4], oa[5]); wa.w = pk2(oa[6], oa[7]);
    wc.x = pk2(oc[0], oc[1]); wc.y = pk2(oc[2], oc[3]); wc.z = pk2(oc[4], oc[5]); wc.w = pk2(oc[6], oc[7]);
    *(u32x4*)(mr + 8 * lane) = wa; *(u32x4*)(mr + 512 + 8 * lane) = wc;
}

template <bool HAS_Y, bool HAS_NEXT>
__device__ __forceinline__ void rowpass(int row, int lane, const float* xsrc, float* xdst, bf16_t* yh, const float* g_post, const float* g_next) {
    const size_t ro = (size_t)row * DM;
    f32x4 x[4];
#pragma unroll
    for (int j = 0; j < 2; ++j)
#pragma unroll
        for (int k = 0; k < 2; ++k) x[2 * j + k] = *(const f32x4*)(xsrc + ro + 8 * lane + 512 * j + 4 * k);
    if (HAS_Y) {
        float y[16]; float ss = 0.f;
#pragma unroll
        for (int j = 0; j < 2; ++j) { const u32x4 v = *(const u32x4*)(yh + ro + 8 * lane + 512 * j);
            y[8 * j + 0] = bflo(v.x); y[8 * j + 1] = bfhi(v.x); y[8 * j + 2] = bflo(v.y); y[8 * j + 3] = bfhi(v.y);
            y[8 * j + 4] = bflo(v.z); y[8 * j + 5] = bfhi(v.z); y[8 * j + 6] = bflo(v.w); y[8 * j + 7] = bfhi(v.w); }
#pragma unroll
        for (int i = 0; i < 16; ++i) ss += y[i] * y[i];
        const float rs = rsqrtf(wave_sum(ss) * (1.0f / 1024.0f) + EPS);
#pragma unroll
        for (int j = 0; j < 2; ++j)
#pragma unroll
            for (int k = 0; k < 2; ++k) { const f32x4 gp = *(const f32x4*)(g_post + 8 * lane + 512 * j + 4 * k);
#pragma unroll
                for (int e = 0; e < 4; ++e) x[2 * j + k][e] += y[8 * j + 4 * k + e] * rs * gp[e];
                *(f32x4*)(xdst + ro + 8 * lane + 512 * j + 4 * k) = x[2 * j + k]; }
    }
    if (HAS_NEXT) {
        float ss = 0.f;
#pragma unroll
        for (int q = 0; q < 4; ++q)
#pragma unroll
            for (int e = 0; e < 4; ++e) ss += x[q][e] * x[q][e];
        const float rs = rsqrtf(wave_sum(ss) * (1.0f / 1024.0f) + EPS);
#pragma unroll
        for (int j = 0; j < 2; ++j) { const f32x4 g0 = *(const f32x4*)(g_next + 8 * lane + 512 * j), g1 = *(const f32x4*)(g_next + 8 * lane + 512 * j + 4);
            const f32x4 a = x[2 * j], b = x[2 * j + 1]; u32x4 w;
            w.x = pk2(a[0] * rs * g0[0], a[1] * rs * g0[1]); w.y = pk2(a[2] * rs * g0[2], a[3] * rs * g0[3]);
            w.z = pk2(b[0] * rs * g1[0], b[1] * rs * g1[1]); w.w = pk2(b[2] * rs * g1[2], b[3] * rs * g1[3]);
            *(u32x4*)(yh + ro + 8 * lane + 512 * j) = w; }
    }
}

__device__ __forceinline__ void tr_item(const float* W, int K, int N, bf16_t* WT, int n0, int k0, int srccol, float scale, LAS float* scr, int lane) {
#pragma unroll 8
    for (int i = 0; i < 32; ++i) { const int kk = 2 * i + (lane >> 5); scr[kk * 33 + (lane & 31)] = (srccol >= 0) ? W[(size_t)(k0 + kk) * N + srccol] * scale : 0.f; }
    asm volatile("s_waitcnt lgkmcnt(0)" ::: "memory");
    const int c = lane & 7;
#pragma unroll
    for (int j = 0; j < 4; ++j) { const int n = (lane >> 3) + 8 * j; const LAS float* s = scr + (8 * c) * 33 + n;
        u32x4 o; o.x = pk2(s[0 * 33], s[1 * 33]); o.y = pk2(s[2 * 33], s[3 * 33]); o.z = pk2(s[4 * 33], s[5 * 33]); o.w = pk2(s[6 * 33], s[7 * 33]);
        *(u32x4*)(WT + (size_t)(n0 + n) * K + k0 + 8 * c) = o; }
    asm volatile("s_waitcnt lgkmcnt(0)" ::: "memory");
}
__device__ __forceinline__ int inproj_src(int n, float& scale) {
    scale = 1.0f;
    if (n < 256) { scale = 0.125f * LOG2E; return S_FQ + n; }
    if (n < 512) return S_FK + (n - 256);
    if (n < 768) return S_FV + (n - 512);
    if (n < C_KR) return -2;
    if (n < C_FF) return S_KR + (n - C_KR);
    if (n < C_FF + 4) return S_FF + (n - C_FF);
    if (n < C_CQ) return -1;
    if (n < C_CKV) return S_CQ + (n - C_CQ);
    if (n < C_CKV + 128) return S_CKV + (n - C_CKV);
    if (n < C_RQ) return -1;
    if (n < C_RK) return S_RQ + (n - C_RQ);
    if (n < C_RV) { scale = 0.125f; return S_RK + (n - C_RK); }
    if (n < C_RG) return S_RV + (n - C_RV);
    if (n < C_SQ) return S_RG + (n - C_RG);
    if (n < C_SK) { scale = 0.125f * LOG2E; return S_SQ + (n - C_SQ); }
    if (n < C_SV) return S_SK + (n - C_SK);
    return S_SV + (n - C_SV);
}
template <int R>
__device__ __forceinline__ void fold_item(const float* w_in, int cb, const float* g, const float* Wup, int NU, bf16_t* WT, int dst0, float scale, int k0, int nb0, int lane) {
    float acc[16];
#pragma unroll
    for (int n = 0; n < 16; ++n) acc[n] = 0.f;
    const float* wrow = w_in + (size_t)(k0 + lane) * WIN_N + cb;
#pragma unroll 1
    for (int r0 = 0; r0 < R; r0 += 4) {
        float w[4];
#pragma unroll
        for (int i = 0; i < 4; ++i) w[i] = wrow[r0 + i] * g[r0 + i];
#pragma unroll
        for (int i = 0; i < 4; ++i) { const float* up = Wup + (size_t)(r0 + i) * NU + nb0;
#pragma unroll
            for (int n = 0; n < 16; ++n) acc[n] = fmaf(w[i], up[n], acc[n]); }
    }
#pragma unroll
    for (int n = 0; n < 16; ++n) WT[(size_t)(dst0 + nb0 + n) * DM + k0 + lane] = (bf16_t)(pk2(acc[n] * scale, 0.f) & 0xffffu);
}

#define G ((int)gridDim.x)
#define gw ((int)blockIdx.x * 8 + wid)
#define NGW ((int)gridDim.x * 8)
#define PRM(f) (((const volatile __attribute__((address_space(4))) Params*)__builtin_amdgcn_kernarg_segment_ptr())->f)
#define WSB ((unsigned char*)PRM(ws))
#define WinT ((bf16_t*)(WSB + WS_WIN))
#define WoutT ((bf16_t*)(WSB + WS_WOUT))
#define WupT ((bf16_t*)(WSB + WS_WUP))
#define WdnT ((bf16_t*)(WSB + WS_WDN))
#define FL ((float*)(WSB + WS_FL))
#define HB ((bf16_t*)(WSB + WS_H))
#define MIX ((bf16_t*)(WSB + WS_MIX))
#define PROJ ((bf16_t*)(WSB + WS_PROJ))
#define CTR ((unsigned*)(WSB + WS_CTL))


template <int layer>
__device__ __forceinline__ void layer_fwd(LAS unsigned char* lds, cg::grid_group& grid, const int lane_in, const int wid) {
#define LAUNDER_LANE() int lane = lane_in; asm volatile("" : "+v"(lane))
        { pg8::Gemm g{HB, WinT + (size_t)layer * NP * DM, T, NP, DM}; pg8::StaticOrder S; S.init(T, NP, G, (int)blockIdx.x);
          pg8::EpiBf16<0> E{PROJ, NP};
          pg8::gemm_phase<pg8::EpiBf16<0>, pg8::StaticOrder, true, true>(lds, g, S, E); }
        grid.sync();
        { LAUNDER_LANE(); const int* pos = PRM(pos); const float* bf_ = PRM(b_forget) + layer * 4; bf16_t* pj = PROJ; float* fl_ = FL;
          for (int m = gw; m < T; m += NGW) fixup_row(pos, bf_, m, lane, pj, fl_); }
        grid.sync();
        att::attn_phase(PROJ, FL, MIX, CTR + 64 * layer, lds);
        grid.sync();
        { LAUNDER_LANE(); const float* g_ = PRM(g_mix_out) + layer * DM; bf16_t* mx = MIX; const bf16_t* pj = PROJ;
          for (int m = gw; m < T; m += NGW) mixnorm_row(g_, m, lane, mx, pj); }
        grid.sync();
        { pg8::Gemm g{MIX, WoutT + (size_t)layer * DM * DM, T, DM, DM}; pg8::StaticOrder S; S.init(T, DM, G, (int)blockIdx.x);
          pg8::EpiBf16<0> E{HB, DM};
          pg8::gemm_phase<pg8::EpiBf16<0>, pg8::StaticOrder, true, true>(lds, g, S, E); }
        grid.sync();
        { LAUNDER_LANE(); float* o_ = PRM(out); const float* xs = layer == 0 ? PRM(x) : (const float*)o_; bf16_t* hb = HB; const float* gp = PRM(g_mix_post) + layer * DM; const float* gn = PRM(g_ffn_pre) + layer * DM;
          for (int m = gw; m < T; m += NGW) rowpass<true, true>(m, lane, xs, o_, hb, gp, gn); }
        grid.sync();
        { pg8::Gemm g{HB, WupT + (size_t)layer * FF * DM, T, FF, DM}; pg8::StaticOrder S; S.init(T, FF, G, (int)blockIdx.x);
          pg8::EpiBf16<1> E{PROJ, FF};
          pg8::gemm_phase<pg8::EpiBf16<1>, pg8::StaticOrder, true, true>(lds, g, S, E); }
        grid.sync();
        { pg8::Gemm g{PROJ, WdnT + (size_t)layer * DM * FF, T, DM, FF}; pg8::StaticOrder S; S.init(T, DM, G, (int)blockIdx.x);
          pg8::EpiBf16<0> E{HB, DM};
          pg8::gemm_phase<pg8::EpiBf16<0>, pg8::StaticOrder, true, true>(lds, g, S, E); }
        grid.sync();
        if (layer + 1 < DEPTH) {
            LAUNDER_LANE(); float* o_ = PRM(out); bf16_t* hb = HB; const float* gp = PRM(g_ffn_post) + layer * DM; const float* gn = PRM(g_mix_pre) + (layer + 1) * DM;
            for (int m = gw; m < T; m += NGW) rowpass<true, true>(m, lane, o_, o_, hb, gp, gn);
            grid.sync();
        } else {
            LAUNDER_LANE(); float* o_ = PRM(out); bf16_t* hb = HB; const float* gp = PRM(g_ffn_post) + layer * DM;
            for (int m = gw; m < T; m += NGW) rowpass<true, false>(m, lane, o_, o_, hb, gp, nullptr);
        }
    }

__global__ void __launch_bounds__(512) mega_fwd(Params p_unused) {
    extern __shared__ __attribute__((aligned(16))) unsigned char lds_raw[];
    LAS unsigned char* lds = (LAS unsigned char*)lds_raw;
    cg::grid_group grid = cg::this_grid();
    const int tid = threadIdx.x, lane = tid & 63, wid = __builtin_amdgcn_readfirstlane(tid >> 6);
    {
        LAS float* scr = (LAS float*)(lds + wid * 8448);
        constexpr int I_IN = 128 * 16, I_OUT = 32 * 16, I_UP = 128 * 16, I_DN = 32 * 64, I_FQ = 16 * 24, I_FKV = 16 * 32;
        constexpr int I_LAYER = I_IN + I_OUT + I_UP + I_DN + I_FQ + I_FKV;
        const float* w_in_ = PRM(w_in); const float* w_out_ = PRM(w_out); const float* w_up_ = PRM(w_up); const float* w_down_ = PRM(w_down);
        const float* g_q_ = PRM(g_q); const float* w_q_up_ = PRM(w_q_up); const float* g_kv_ = PRM(g_kv); const float* w_kv_up_ = PRM(w_kv_up);
        bf16_t* WinT_ = WinT; bf16_t* WoutT_ = WoutT; bf16_t* WupT_ = WupT; bf16_t* WdnT_ = WdnT;
        for (int it = gw; it < DEPTH * I_LAYER; it += NGW) {
            const int layer = it / I_LAYER; int r = it - layer * I_LAYER;
            if (r < I_IN) { const int nb = r >> 4, kb = r & 15; float sc; const int src = inproj_src(nb * 32 + (lane & 31), sc);
                if (nb * 32 >= C_MQ && nb * 32 < C_KR) continue;
                tr_item(w_in_ + (size_t)layer * DM * WIN_N, DM, WIN_N, WinT_ + (size_t)layer * NP * DM, nb * 32, kb * 64, src, sc, scr, lane); continue; }
            r -= I_IN;
            if (r < I_OUT) { const int nb = r >> 4, kb = r & 15;
                tr_item(w_out_ + (size_t)layer * DM * DM, DM, DM, WoutT_ + (size_t)layer * DM * DM, nb * 32, kb * 64, nb * 32 + (lane & 31), 1.0f, scr, lane); continue; }
            r -= I_OUT;
            if (r < I_UP) { const int nb = r >> 4, kb = r & 15;
                tr_item(w_up_ + (size_t)layer * DM * FF, DM, FF, WupT_ + (size_t)layer * FF * DM, nb * 32, kb * 64, nb * 32 + (lane & 31), 1.0f, scr, lane); continue; }
            r -= I_UP;
            if (r < I_DN) { const int nb = r >> 6, kb = r & 63;
                tr_item(w_down_ + (size_t)layer * FF * DM, FF, DM, WdnT_ + (size_t)layer * DM * FF, nb * 32, kb * 64, nb * 32 + (lane & 31), 1.0f, scr, lane); continue; }
            r -= I_DN;
            if (r < I_FQ) { const int kb = r / 24, nb = r % 24;
                fold_item<256>(w_in_ + (size_t)layer * DM * WIN_N, S_CQ, g_q_ + layer * 256, w_q_up_ + (size_t)layer * 256 * 384, 384, WinT_ + (size_t)layer * NP * DM, C_MQ,
                               0.10206207261596575f * LOG2E, kb * 64, nb * 16, lane); continue; }
            r -= I_FQ;
            { const int kb = r / 32, nb = r % 32;
              fold_item<128>(w_in_ + (size_t)layer * DM * WIN_N, S_CKV, g_kv_ + layer * 128, w_kv_up_ + (size_t)layer * 128 * 512, 512, WinT_ + (size_t)layer * NP * DM, C_MKV,
                             1.0f, kb * 64, nb * 16, lane); }
        }
        { const float* x_ = PRM(x); bf16_t* hb = HB; const float* gn = PRM(g_mix_pre);
          for (int m = gw; m < T; m += NGW) rowpass<false, true>(m, lane, x_, nullptr, hb, nullptr, gn); }
    }
    grid.sync();

    layer_fwd<0>(lds, grid, lane, wid);
    layer_fwd<1>(lds, grid, lane, wid);
}
#undef G
#undef gw
#undef NGW
#undef PRM
#undef WSB
#undef WinT
#undef WoutT
#undef WupT
#undef WdnT
#undef FL
#undef HB
#undef MIX
#undef PROJ
#undef CTR
extern "C" void kernel_launch(void* const* d_in, const int* in_sizes, int n_in, void* d_out, int out_size, void* d_ws, size_t ws_size, hipStream_t stream) {
    static int grid = 0;
    if (grid == 0) {
        if (n_in != 16 || out_size != T * DM || ws_size < WS_END) { fprintf(stderr, "kernel_launch: unexpected shapes (n_in %d, out %d, ws %zu)\n", n_in, out_size, ws_size); grid = -1; return; }
        int dev = 0, cus = 0, per_cu = 0;
        (void)hipGetDevice(&dev);
        (void)hipDeviceGetAttribute(&cus, hipDeviceAttributeMultiprocessorCount, dev);
        if (hipFuncSetAttribute((const void*)mega_fwd, hipFuncAttributeMaxDynamicSharedMemorySize, LDS_BYTES) != hipSuccess) fprintf(stderr, "kernel_launch: hipFuncSetAttribute failed\n");
        if (hipOccupancyMaxActiveBlocksPerMultiprocessor(&per_cu, (const void*)mega_fwd, 512, LDS_BYTES) != hipSuccess || per_cu < 1) { fprintf(stderr, "kernel_launch: occupancy query gave %d\n", per_cu); per_cu = 1; }
        (void)hipGetLastError();
        grid = cus * per_cu;
        if (grid <= 0) grid = 256;
    }
    if (grid < 0) return;
    (void)hipMemsetAsync((char*)d_ws + WS_CTL, 0, 4096, stream);
    Params p{};
    p.x = (const float*)d_in[0]; p.pos = (const int*)d_in[1]; p.g_mix_pre = (const float*)d_in[2]; p.w_in = (const float*)d_in[3]; p.b_forget = (const float*)d_in[4];
    p.g_q = (const float*)d_in[5]; p.w_q_up = (const float*)d_in[6]; p.g_kv = (const float*)d_in[7]; p.w_kv_up = (const float*)d_in[8]; p.g_mix_out = (const float*)d_in[9];
    p.w_out = (const float*)d_in[10]; p.g_mix_post = (const float*)d_in[11]; p.g_ffn_pre = (const float*)d_in[12]; p.w_up = (const float*)d_in[13]; p.w_down = (const float*)d_in[14];
    p.g_ffn_post = (const float*)d_in[15]; p.out = (float*)d_out; p.ws = (unsigned char*)d_ws;
    void* args[] = {&p};
    hipError_t e = hipLaunchCooperativeKernel((const void*)mega_fwd, dim3(grid), dim3(512), args, LDS_BYTES, stream);
    if (e != hipSuccess) fprintf(stderr, "kernel_launch: cooperative launch failed: %s (grid %d)\n", hipGetErrorString(e), grid);
}
```
